# Optimizing an MI355X kernel written in HIP

```python
import math
import jax
import jax.numpy as jnp
from jax import lax
import numpy as np

D_MODEL = 1024
BATCH = 8
SEQ = 4096
DEPTH = 1

HEAD_DIM = 64
N_HEADS_NA = 8
N_HEADS_DIL = 8
N_HEADS = N_HEADS_NA + N_HEADS_DIL
D_NA = N_HEADS_NA * HEAD_DIM
D_DIL = N_HEADS_DIL * HEAD_DIM
D_MIX = D_NA + D_DIL
D_FF = 2816
GRID_W = 64
NA_KH = 8
NA_KW = 16
NA_COL_BLOCK = 16
NA_COL_SPAN = 32
DIL_PATTERNS = ((128, 1), (512, 4), (2048, 16))
DIL_QBLOCK = 128
T5_BUCKETS = 32
T5_MAX_DIST = 1024
NORM_EPS = 1e-6
MASK_VALUE = -1e30

kernel_name = 'hybrid_na_dilated_macaron_layer'


def rmsnorm(x, g):
    xf = x.astype(jnp.float32)
    y = xf * lax.rsqrt(jnp.mean(xf * xf, axis=-1, keepdims=True) + NORM_EPS)
    return (y * g.astype(jnp.float32)).astype(x.dtype)


def swiglu(x, w_gate, w_up, w_down):
    return (jax.nn.silu(x @ w_gate) * (x @ w_up)) @ w_down


def t5_bucket(rel):
    nb = T5_BUCKETS // 2
    max_exact = nb // 2
    n = jnp.abs(rel)
    large = max_exact + (jnp.log(jnp.maximum(n, 1).astype(jnp.float32) / max_exact)
                         / math.log(T5_MAX_DIST / max_exact) * (nb - max_exact)).astype(jnp.int32)
    large = jnp.minimum(large, nb - 1)
    return jnp.where(rel > 0, nb, 0) + jnp.where(n < max_exact, n, large)


def neighbourhood_attention(q, k, v, rel_bias):
    B, H, S, Dh = q.shape
    rows = S // GRID_W
    kh = min(NA_KH, rows)
    ncb = GRID_W // NA_COL_BLOCK
    n_keys = kh * NA_COL_SPAN
    r = jnp.arange(rows)
    key_rows = jnp.clip(r - kh // 2, 0, rows - kh)[:, None] + jnp.arange(kh)[None, :]
    cb = jnp.arange(ncb)
    key_cols = (jnp.clip(cb * NA_COL_BLOCK - NA_KW // 2, 0, GRID_W - NA_COL_SPAN)[:, None]
                + jnp.arange(NA_COL_SPAN)[None, :])
    key_idx = (key_rows[:, None, :, None] * GRID_W
               + key_cols[None, :, None, :]).reshape(rows, ncb, n_keys)
    kr = jnp.repeat(key_rows, NA_COL_SPAN, axis=1)
    kc = jnp.tile(key_cols, (1, kh))
    q_col = cb[:, None] * NA_COL_BLOCK + jnp.arange(NA_COL_BLOCK)[None, :]
    q_col_start = jnp.clip(q_col - NA_KW // 2, 0, GRID_W - NA_KW)
    col_valid = ((kc[:, None, :] >= q_col_start[:, :, None])
                 & (kc[:, None, :] < q_col_start[:, :, None] + NA_KW))
    dc_idx = jnp.clip(kc[:, None, :] - q_col[:, :, None] + NA_KW - 1, 0, 2 * NA_KW - 2)
    dr_idx = kr - r[:, None] + NA_KH - 1
    scale = HEAD_DIM ** -0.5
    q_rows = jnp.moveaxis(q.reshape(B, H, rows, ncb, NA_COL_BLOCK, Dh), 2, 0)

    def row_block(args):
        q_r, idx_r, dr_r = args
        k_r = k[:, :, idx_r]
        v_r = v[:, :, idx_r]
        s = jnp.einsum('bhnqe,bhnke->bhnqk', q_r, k_r,
                       preferred_element_type=jnp.float32) * scale
        bias = rel_bias[:, dr_r[None, None, :], dc_idx].astype(jnp.float32)
        s = jnp.where(col_valid, s + bias, MASK_VALUE)
        p = jax.nn.softmax(s, axis=-1)
        return jnp.einsum('bhnqk,bhnke->bhnqe', p.astype(v.dtype), v_r)

    out = lax.map(row_block, (q_rows, key_idx, dr_idx))
    return jnp.moveaxis(out, 0, 2).reshape(B, H, S, Dh)


def dilated_window_attention(q, k, v, t5_bias, window, dilation):
    B, H, S, Dh = q.shape
    radius = window // (2 * dilation)
    L = S // dilation
    qb = min(DIL_QBLOCK, L)
    nb = -(-L // qb)
    Lp = nb * qb
    kb_len = qb + 2 * radius

    def to_sub(t):
        return t.reshape(B, H, L, dilation, Dh).transpose(0, 1, 3, 2, 4)

    qs = jnp.pad(to_sub(q), ((0, 0), (0, 0), (0, 0), (0, Lp - L), (0, 0))).reshape(B, H, dilation, nb, qb, Dh)
    pad_k = ((0, 0), (0, 0), (0, 0), (radius, radius + Lp - L), (0, 0))
    ks = jnp.pad(to_sub(k), pad_k)
    vs = jnp.pad(to_sub(v), pad_k)
    k_idx = jnp.arange(nb)[:, None] * qb + jnp.arange(kb_len)[None, :]
    k_blk = ks[:, :, :, k_idx]
    v_blk = vs[:, :, :, k_idx]
    q_pos = jnp.arange(nb)[:, None] * qb + jnp.arange(qb)[None, :]
    k_pos = k_idx - radius
    off = k_pos[:, None, :] - q_pos[:, :, None]
    valid = (jnp.abs(off) <= radius) & (k_pos[:, None, :] >= 0) & (k_pos[:, None, :] < L)
    bias = t5_bias[:, t5_bucket(off * dilation)].astype(jnp.float32)
    s = jnp.einsum('bhdnqe,bhdnke->bhdnqk', qs, k_blk,
                   preferred_element_type=jnp.float32) * HEAD_DIM ** -0.5
    s = jnp.where(valid, s + bias[:, None], MASK_VALUE)
    m = jnp.max(s, axis=-1, keepdims=True)
    p = jnp.exp(s - m)
    den = jnp.sum(p, axis=-1)
    o = jnp.einsum('bhdnqk,bhdnke->bhdnqe', p.astype(v.dtype), v_blk,
                   preferred_element_type=jnp.float32) / den[..., None]
    lse = m[..., 0] + jnp.log(den)
    o = o.reshape(B, H, dilation, Lp, Dh)[:, :, :, :L].transpose(0, 1, 3, 2, 4).reshape(B, H, S, Dh)
    lse = lse.reshape(B, H, dilation, Lp)[..., :L].transpose(0, 1, 3, 2).reshape(B, H, S)
    return o, lse


def dilated_mixture_attention(q, k, v, t5_bias):
    results = [dilated_window_attention(q, k, v, t5_bias, w, d) for w, d in DIL_PATTERNS]
    outs = jnp.stack([res[0] for res in results])
    lses = jnp.stack([res[1] for res in results])
    wts = jax.nn.softmax(lses, axis=0)
    return jnp.sum(wts[..., None] * outs, axis=0).astype(q.dtype)


def setup_inputs(seed: int = 0) -> dict:
    key = jax.random.key(seed)
    ks = jax.random.split(key, 20)

    def nrm(k, shape, scale):
        return jax.random.normal(k, shape, jnp.float32) * scale

    def gain(k, shape):
        return 1.0 + 0.05 * jax.random.normal(k, shape, jnp.float32)

    return {
        'x': nrm(ks[0], (BATCH, SEQ, D_MODEL), 1.0),
        'ffn1_pre_g': gain(ks[1], (DEPTH, D_MODEL)),
        'ffn1_w_gate': nrm(ks[2], (DEPTH, D_MODEL, D_FF), D_MODEL ** -0.5),
        'ffn1_w_up': nrm(ks[3], (DEPTH, D_MODEL, D_FF), D_MODEL ** -0.5),
        'ffn1_w_down': nrm(ks[4], (DEPTH, D_FF, D_MODEL), D_FF ** -0.5),
        'ffn1_post_g': gain(ks[5], (DEPTH, D_MODEL)),
        'mix_pre_g': gain(ks[6], (DEPTH, D_MODEL)),
        'w_qkv': nrm(ks[7], (DEPTH, D_MODEL, 3 * D_MIX), D_MODEL ** -0.5),
        'na_rel_bias': nrm(ks[8], (DEPTH, N_HEADS_NA, 2 * NA_KH - 1, 2 * NA_KW - 1), 0.5),
        't5_rel_bias': nrm(ks[9], (N_HEADS_DIL, T5_BUCKETS), 0.5),
        'na_out_g': gain(ks[10], (DEPTH, D_NA)),
        'dil_out_g': gain(ks[11], (DEPTH, D_DIL)),
        'w_out': nrm(ks[12], (DEPTH, D_MIX, D_MODEL), D_MIX ** -0.5),
        'mix_post_g': gain(ks[13], (DEPTH, D_MODEL)),
        'ffn2_pre_g': gain(ks[14], (DEPTH, D_MODEL)),
        'ffn2_w_gate': nrm(ks[15], (DEPTH, D_MODEL, D_FF), D_MODEL ** -0.5),
        'ffn2_w_up': nrm(ks[16], (DEPTH, D_MODEL, D_FF), D_MODEL ** -0.5),
        'ffn2_w_down': nrm(ks[17], (DEPTH, D_FF, D_MODEL), D_FF ** -0.5),
        'ffn2_post_g': gain(ks[18], (DEPTH, D_MODEL)),
    }


def reference(x, ffn1_pre_g, ffn1_w_gate, ffn1_w_up, ffn1_w_down, ffn1_post_g,
              mix_pre_g, w_qkv, na_rel_bias, t5_rel_bias, na_out_g, dil_out_g, w_out,
              mix_post_g, ffn2_pre_g, ffn2_w_gate, ffn2_w_up, ffn2_w_down, ffn2_post_g):
    B, S, _ = x.shape
    for l in range(DEPTH):
        h = swiglu(rmsnorm(x, ffn1_pre_g[l]), ffn1_w_gate[l], ffn1_w_up[l], ffn1_w_down[l])
        x = x + 0.5 * rmsnorm(h, ffn1_post_g[l])
        h = rmsnorm(x, mix_pre_g[l])
        qkv = (h @ w_qkv[l]).reshape(B, S, 3, N_HEADS, HEAD_DIM).transpose(2, 0, 3, 1, 4)
        q, k, v = qkv[0], qkv[1], qkv[2]
        o_na = neighbourhood_attention(q[:, :N_HEADS_NA], k[:, :N_HEADS_NA], v[:, :N_HEADS_NA],
                                       na_rel_bias[l])
        o_dil = dilated_mixture_attention(q[:, N_HEADS_NA:], k[:, N_HEADS_NA:], v[:, N_HEADS_NA:],
                                          t5_rel_bias)
        o_na = rmsnorm(o_na.transpose(0, 2, 1, 3).reshape(B, S, D_NA), na_out_g[l])
        o_dil = rmsnorm(o_dil.transpose(0, 2, 1, 3).reshape(B, S, D_DIL), dil_out_g[l])
        mixed = jnp.concatenate([o_na, o_dil], axis=-1) @ w_out[l]
        x = x + rmsnorm(mixed, mix_post_g[l])
        h = swiglu(rmsnorm(x, ffn2_pre_g[l]), ffn2_w_gate[l], ffn2_w_up[l], ffn2_w_down[l])
        x = x + 0.5 * rmsnorm(h, ffn2_post_g[l])
    return x
```

```cpp
#define MK_N_LAUNCHES 11
#include <hip/hip_runtime.h>
#include <cstdio>
#include <cstdint>
#include <cmath>
namespace pg8 {
#define PG8_LAS __attribute__((address_space(3)))
typedef unsigned short bf16_t;
typedef short bf16x8 __attribute__((ext_vector_type(8)));
typedef float f32x4 __attribute__((ext_vector_type(4)));
typedef unsigned u32x4 __attribute__((ext_vector_type(4)));
constexpr int BM = 256, BK = 64, HALF = 128, HTB = HALF * BK * 2  , STAGE_BYTES = 8 * HTB, NXCD = 8, WGM = 8;

__host__ __device__ __forceinline__ int lds_byte(int r, int c) { const int st = (r >> 4) * 2 + (c >> 5), rr = r & 15, cc = c & 31, ob = rr * 64 + cc * 2; return st * 1024 + (ob ^ (((ob >> 9) & 1) << 5)); }
__host__ __device__ __forceinline__ void stage_rc(int b, int& R, int& C) { const int st = b / 1024, sb = b % 1024, swz = sb ^ (((sb >> 9) & 1) << 5); R = (st >> 1) * 16 + swz / 64; C = (st & 1) * 32 + (swz % 64) / 2; }
__host__ __device__ __forceinline__ int perm32(int rho) { const int n = rho >> 4, i = rho & 15; return 8 * (i >> 2) + 4 * n + (i & 3); }

struct Unit { int pm, pn; };
struct Gemm { const bf16_t* A; const bf16_t* Bt; int M, N, K; };

struct StaticOrder {
    int nM, nN, nwg, G, c;
    __host__ __device__ void init(int M, int N, int G_, int c_) { nM = M / BM; nN = N / BM; nwg = nM * nN; G = G_; c = c_; }
    __host__ __device__ bool next(int i, Unit& u) const {
        const long L = (long)i * G + c; if (L >= nwg) return false;
        int wgid = (int)L; { const int q = nwg / NXCD, r = nwg % NXCD, xcd = wgid % NXCD, off = wgid / NXCD; wgid = (xcd < r ? xcd * (q + 1) : r * (q + 1) + (xcd - r) * q) + off; }
        const int nig = WGM * nN, gid = wgid / nig, fm = gid * WGM, gsz = (nM - fm) < WGM ? (nM - fm) : WGM;
        u.pm = fm + ((wgid % nig) % gsz); u.pn = (wgid % nig) / gsz; return true;
    }
    __device__ __forceinline__ void a_ready(const Unit&) const {}
    __device__ __forceinline__ void done(const Unit&) const {}
};

__device__ __forceinline__ unsigned cvt_pk_bf16(float lo, float hi) { unsigned r; asm volatile("v_cvt_pk_bf16_f32 %0, %1, %2" : "=v"(r) : "v"(lo), "v"(hi)); return r; }

struct EpiBf16 {
    static constexpr bool PERM = true, AFTER_DRAIN = false;
    bf16_t* O; int ldc;
    __device__ __forceinline__ void operator()(const f32x4 (&acc)[2][2][4][2], const Unit& u, int wr, int wc, int fr, int fq) const {
        const int row0 = u.pm * BM + wr * 64 + fr; const int col0 = u.pn * BM + wc * 32 + 8 * fq;
#pragma unroll
        for (int ai = 0; ai < 2; ++ai)
#pragma unroll
            for (int m = 0; m < 4; ++m) { bf16_t* rowp = O + (size_t)(row0 + ai * HALF + m * 16) * ldc + col0;
#pragma unroll
                for (int bj = 0; bj < 2; ++bj) { const f32x4 v0 = acc[ai][bj][m][0], v1 = acc[ai][bj][m][1];
                    u32x4 w; w.x = cvt_pk_bf16(v0[0], v0[1]); w.y = cvt_pk_bf16(v0[2], v0[3]); w.z = cvt_pk_bf16(v1[0], v1[1]); w.w = cvt_pk_bf16(v1[2], v1[3]);
                    *(u32x4*)(rowp + bj * HALF) = w; } }
    }
};
__device__ __forceinline__ float silu_mul(float g, float u) { const float e = __builtin_amdgcn_exp2f(g * -1.4426950408889634f); return g * __builtin_amdgcn_rcpf(1.0f + e) * u; }
struct EpiSwiGLU {
    static constexpr bool PERM = true, AFTER_DRAIN = false;
    bf16_t* H; int ldh;
    __device__ __forceinline__ void operator()(const f32x4 (&acc)[2][2][4][2], const Unit& u, int wr, int wc, int fr, int fq) const {
        const int row0 = u.pm * BM + wr * 64 + fr; const int col0 = u.pn * HALF + wc * 32 + 8 * fq;
#pragma unroll
        for (int ai = 0; ai < 2; ++ai)
#pragma unroll
            for (int m = 0; m < 4; ++m) { bf16_t* rowp = H + (size_t)(row0 + ai * HALF + m * 16) * ldh + col0;
                const f32x4 g0 = acc[ai][0][m][0], g1 = acc[ai][0][m][1], u0 = acc[ai][1][m][0], u1 = acc[ai][1][m][1];
                u32x4 w; w.x = cvt_pk_bf16(silu_mul(g0[0], u0[0]), silu_mul(g0[1], u0[1])); w.y = cvt_pk_bf16(silu_mul(g0[2], u0[2]), silu_mul(g0[3], u0[3]));
                w.z = cvt_pk_bf16(silu_mul(g1[0], u1[0]), silu_mul(g1[1], u1[1])); w.w = cvt_pk_bf16(silu_mul(g1[2], u1[2]), silu_mul(g1[3], u1[3]));
                *(u32x4*)rowp = w; }
    }
};
struct EpiF32Ssq {
    static constexpr bool PERM = false, AFTER_DRAIN = false;
    float* C; int ldc; float* ssq;
    __device__ __forceinline__ void operator()(const f32x4 (&acc)[2][2][4][2], const Unit& u, int wr, int wc, int fr, int fq) const {
        const int row0 = u.pm * BM + wr * 64 + fr, col0 = u.pn * BM + wc * 32 + 4 * fq;
#pragma unroll
        for (int ai = 0; ai < 2; ++ai)
#pragma unroll
            for (int m = 0; m < 4; ++m) { const int row = row0 + ai * HALF + m * 16; float* rowp = C + (size_t)row * ldc + col0; float s = 0.f;
#pragma unroll
                for (int bj = 0; bj < 2; ++bj)
#pragma unroll
                    for (int n = 0; n < 2; ++n) { const f32x4 v = acc[ai][bj][m][n]; *(f32x4*)(rowp + bj * HALF + n * 16) = v; s += (v[0] * v[0] + v[1] * v[1]) + (v[2] * v[2] + v[3] * v[3]); }
                s += __shfl_xor(s, 16); s += __shfl_xor(s, 32);
                if (fq == 0) ssq[(size_t)row * 16 + u.pn * 4 + wc] = s; }
    }
};

template <class Epi, class Sched, bool ALIGN_EPI = false, bool SP2 = false>
__device__ __forceinline__ void gemm_phase(PG8_LAS unsigned char* lds, const Gemm g, const Sched& S, const Epi& E) {
    const int tid = threadIdx.x, wid = __builtin_amdgcn_readfirstlane(tid >> 6), lane = tid & 63, wr = wid >> 2, wc = wid & 3, fr = lane & 15, fq = lane >> 4;
    const int K = g.K, nt = K / BK;
    unsigned voffA[2], voffB[2];
#pragma unroll
    for (int i = 0; i < 2; ++i) { int R, C; stage_rc(tid * 16 + i * 8192, R, C); const int Rb = Epi::PERM ? ((R & ~31) + perm32(R & 31)) : R;
        voffA[i] = (unsigned)(R * K + C) * 2u; voffB[i] = (unsigned)(Rb * K + C) * 2u; }
    const size_t kstep = (size_t)(BK * 2);
    const size_t hstep = (size_t)HALF * K * 2;
    const size_t tstep = 2 * hstep;
    const unsigned ldsw = (unsigned)wid * 1024u;
    const int aoff = lds_byte(wr * 64 + fr, fq * 8), boff = lds_byte(wc * 32 + fr, fq * 8);
#define PG8_SA(b, h) (((b) * 2 + (h)) * HTB)
#define PG8_SB(b, h) ((4 + (b) * 2 + (h)) * HTB)
#define PG8_STAGE(bufoff, gbase, voff) do { _Pragma("unroll") for (int _i = 0; _i < 2; ++_i) \
        __builtin_amdgcn_global_load_lds((const unsigned*)((const char*)(gbase) + (voff)[_i]), (PG8_LAS unsigned*)(lds + (bufoff) + ldsw + _i * 8192), 16, 0, 0); } while (0)
#define PG8_LDA(dst, b, h) do { _Pragma("unroll") for (int m = 0; m < 4; ++m) _Pragma("unroll") for (int k = 0; k < 2; ++k) dst[m][k] = *(const PG8_LAS bf16x8*)(lds + PG8_SA(b, h) + aoff + m * 2048 + k * 1024); } while (0)
#define PG8_LDB(dst, b, h) do { _Pragma("unroll") for (int n = 0; n < 2; ++n) _Pragma("unroll") for (int k = 0; k < 2; ++k) dst[n][k] = *(const PG8_LAS bf16x8*)(lds + PG8_SB(b, h) + boff + n * 2048 + k * 1024); } while (0)
#define PG8_MMA(ai, bj, At, Bt) do { __builtin_amdgcn_s_setprio(1); _Pragma("unroll") for (int m = 0; m < 4; ++m) _Pragma("unroll") for (int n = 0; n < 2; ++n) _Pragma("unroll") for (int k = 0; k < 2; ++k) \
        acc[ai][bj][m][n] = __builtin_amdgcn_mfma_f32_16x16x32_bf16(Bt[n][k], At[m][k], acc[ai][bj][m][n], 0, 0, 0); __builtin_amdgcn_s_setprio(0); } while (0)
#define PG8_WAIT_V(n) asm volatile("s_waitcnt vmcnt(" #n ")" ::: "memory")
#define PG8_WAIT_L(n) asm volatile("s_waitcnt lgkmcnt(" #n ")" ::: "memory")
#define PG8_BAR __builtin_amdgcn_s_barrier()
#define PG8_SCHED __builtin_amdgcn_sched_barrier(0)
    Unit cur, nxt; int ui = 0;
    if (!S.next(0, cur)) return;
    f32x4 acc[2][2][4][2];
#pragma unroll
    for (int a = 0; a < 2; ++a)
#pragma unroll
        for (int b = 0; b < 2; ++b)
#pragma unroll
            for (int m = 0; m < 4; ++m)
#pragma unroll
                for (int n = 0; n < 2; ++n) acc[a][b][m][n] = (f32x4){0.f, 0.f, 0.f, 0.f};
    bf16x8 At[4][2], B0[2][2], B1[2][2];
    const char* cA = (const char*)g.A + (size_t)cur.pm * tstep; const char* cB = (const char*)g.Bt + (size_t)cur.pn * tstep;
    S.a_ready(cur);
    if constexpr (SP2) {
        PG8_STAGE(PG8_SB(0, 0), cB, voffB); PG8_STAGE(PG8_SB(0, 1), cB + hstep, voffB); PG8_STAGE(PG8_SA(0, 0), cA, voffA); PG8_STAGE(PG8_SA(0, 1), cA + hstep, voffA);
        if (wr == 1) PG8_BAR;
        PG8_WAIT_V(2); PG8_BAR;
        PG8_STAGE(PG8_SB(1, 0), cB + kstep, voffB); PG8_STAGE(PG8_SA(1, 0), cA + kstep, voffA); PG8_STAGE(PG8_SB(1, 1), cB + hstep + kstep, voffB);
        PG8_WAIT_V(6); PG8_BAR;
    } else {
        PG8_STAGE(PG8_SB(0, 0), cB, voffB); PG8_STAGE(PG8_SA(0, 0), cA, voffA); PG8_STAGE(PG8_SB(0, 1), cB + hstep, voffB); PG8_STAGE(PG8_SA(0, 1), cA + hstep, voffA);
        if (wr == 1) PG8_BAR;
        PG8_WAIT_V(4); PG8_BAR;
        PG8_STAGE(PG8_SB(1, 0), cB + kstep, voffB); PG8_STAGE(PG8_SA(1, 0), cA + kstep, voffA); PG8_STAGE(PG8_SB(1, 1), cB + hstep + kstep, voffB);
        PG8_WAIT_V(6); PG8_BAR;
    }
    for (;;) {
        const bool has_next = S.next(ui + 1, nxt);
        const char* nA = has_next ? (const char*)g.A + (size_t)nxt.pm * tstep : cA; const char* nB = has_next ? (const char*)g.Bt + (size_t)nxt.pn * tstep : cB;
        for (int t = 0; t < nt; t += 2) {
            const bool last = (t == nt - 2);
            const char* a1 = cA + (size_t)(t + 1) * kstep;
            const char* a2 = last ? nA : cA + (size_t)(t + 2) * kstep; const char* b2 = last ? nB : cB + (size_t)(t + 2) * kstep;
            const char* a3 = a2 + kstep; const char* b3 = b2 + kstep;
            if (last && has_next) S.a_ready(nxt);
            if constexpr (SP2) {
            PG8_LDB(B0, 0, 0); PG8_LDB(B1, 0, 1); PG8_SCHED; PG8_LDA(At, 0, 0); PG8_STAGE(PG8_SA(1, 1), a1 + hstep, voffA);
            PG8_WAIT_V(8); PG8_WAIT_L(0); PG8_BAR; PG8_MMA(0, 0, At, B0); PG8_MMA(0, 1, At, B1); PG8_BAR; PG8_SCHED;
            PG8_LDA(At, 0, 1); PG8_STAGE(PG8_SB(0, 0), b2, voffB); PG8_STAGE(PG8_SB(0, 1), b2 + hstep, voffB); PG8_STAGE(PG8_SA(0, 0), a2, voffA);
            PG8_WAIT_V(8); PG8_WAIT_L(0); PG8_BAR; PG8_MMA(1, 0, At, B0); PG8_MMA(1, 1, At, B1); PG8_BAR; PG8_SCHED;
            PG8_LDB(B0, 1, 0); PG8_LDB(B1, 1, 1); PG8_SCHED; PG8_LDA(At, 1, 0); PG8_STAGE(PG8_SA(0, 1), a2 + hstep, voffA);
            PG8_WAIT_V(8); PG8_WAIT_L(0); PG8_BAR; PG8_MMA(0, 0, At, B0); PG8_MMA(0, 1, At, B1); PG8_BAR; PG8_SCHED;
            PG8_LDA(At, 1, 1); PG8_STAGE(PG8_SB(1, 0), b3, voffB); PG8_STAGE(PG8_SB(1, 1), b3 + hstep, voffB); PG8_STAGE(PG8_SA(1, 0), a3, voffA);
            PG8_WAIT_V(8); PG8_WAIT_L(0); PG8_BAR; PG8_MMA(1, 0, At, B0); PG8_MMA(1, 1, At, B1); PG8_BAR; PG8_SCHED;
            } else {
            PG8_LDB(B0, 0, 0); PG8_SCHED; PG8_LDA(At, 0, 0); PG8_STAGE(PG8_SA(1, 1), a1 + hstep, voffA);
            PG8_WAIT_L(8); PG8_BAR; PG8_WAIT_L(0); PG8_MMA(0, 0, At, B0); PG8_BAR; PG8_SCHED;
            PG8_LDB(B1, 0, 1); PG8_STAGE(PG8_SB(0, 0), b2, voffB);
            PG8_BAR; PG8_WAIT_L(0); PG8_MMA(0, 1, At, B1); PG8_BAR;
            PG8_LDA(At, 0, 1); PG8_STAGE(PG8_SA(0, 0), a2, voffA);
            PG8_BAR; PG8_WAIT_L(0); PG8_MMA(1, 0, At, B0); PG8_BAR; PG8_SCHED;
            PG8_STAGE(PG8_SB(0, 1), b2 + hstep, voffB);
            PG8_WAIT_V(6); PG8_BAR; PG8_MMA(1, 1, At, B1); PG8_BAR;
            PG8_LDB(B0, 1, 0); PG8_SCHED; PG8_LDA(At, 1, 0); PG8_STAGE(PG8_SA(0, 1), a2 + hstep, voffA);
            PG8_WAIT_L(8); PG8_BAR; PG8_WAIT_L(0); PG8_MMA(0, 0, At, B0); PG8_BAR; PG8_SCHED;
            PG8_LDB(B1, 1, 1); PG8_STAGE(PG8_SB(1, 0), b3, voffB);
            PG8_BAR; PG8_WAIT_L(0); PG8_MMA(0, 1, At, B1); PG8_BAR;
            PG8_LDA(At, 1, 1); PG8_STAGE(PG8_SA(1, 0), a3, voffA);
            PG8_BAR; PG8_WAIT_L(0); PG8_MMA(1, 0, At, B0); PG8_BAR; PG8_SCHED;
            PG8_STAGE(PG8_SB(1, 1), b3 + hstep, voffB);
            PG8_WAIT_V(6); PG8_BAR; PG8_MMA(1, 1, At, B1); PG8_BAR;
            }
        }
        if constexpr (ALIGN_EPI) { if (wr == 0) PG8_BAR; }
        if constexpr (!Epi::AFTER_DRAIN) { E(acc, cur, wr, wc, fr, fq); S.done(cur); }
        if (!has_next) break;
#pragma unroll
        for (int a = 0; a < 2; ++a)
#pragma unroll
            for (int b = 0; b < 2; ++b)
#pragma unroll
                for (int m = 0; m < 4; ++m)
#pragma unroll
                    for (int n = 0; n < 2; ++n) acc[a][b][m][n] = (f32x4){0.f, 0.f, 0.f, 0.f};
        cur = nxt; cA = nA; cB = nB; ++ui;
        if constexpr (ALIGN_EPI) { if (wr == 1) PG8_BAR; }
    }
    PG8_WAIT_V(0);
    if constexpr (!ALIGN_EPI) { if (wr == 0) PG8_BAR; }
    PG8_BAR;
    if constexpr (Epi::AFTER_DRAIN) { E.fused(acc, cur, wr, wc, fr, fq, lds, wid, lane); S.done(cur); }
#undef PG8_SA
#undef PG8_SB
#undef PG8_STAGE
#undef PG8_LDA
#undef PG8_LDB
#undef PG8_MMA
#undef PG8_WAIT_V
#undef PG8_WAIT_L
#undef PG8_BAR
#undef PG8_SCHED
}
}
namespace att {
#define ALAS __attribute__((address_space(3)))
typedef short bf16x8 __attribute__((ext_vector_type(8)));
typedef float f32x16 __attribute__((ext_vector_type(16)));
typedef float f32x4 __attribute__((ext_vector_type(4)));
typedef unsigned u32x4 __attribute__((ext_vector_type(4)));
typedef unsigned u32x2 __attribute__((ext_vector_type(2)));
typedef short v4i16_t __attribute__((ext_vector_type(4)));
typedef unsigned short bf16_t;
constexpr int SEQ = 4096, QKV_LD = 3072, O_LD = 1024;
constexpr float LOG2E = 1.4426950408889634f, SC = 0.125f * LOG2E, NEG = -1e30f;
constexpr int TBL_BYTES = 9472;
constexpr int DIL_OFF0 = 1152;
constexpr int LDS_TBL = 0, LDS_VST = 8 * TBL_BYTES, LDS_XS = LDS_VST + 8 * 4096, LDS_BYTES = LDS_XS + 2 * 8 * 32 * 4;
__device__ __forceinline__ unsigned cvtpk(float lo, float hi) { unsigned r; asm volatile("v_cvt_pk_bf16_f32 %0, %1, %2" : "=v"(r) : "v"(lo), "v"(hi)); return r; }
__device__ __forceinline__ v4i16_t trrd(const ALAS unsigned char* p) { return __builtin_amdgcn_ds_read_tr16_b64_v4i16((ALAS v4i16_t*)p); }
struct St { f32x16 o0, o1; float m, l; };

#define ATT_TILE(SCORE_EXPR) do { \
    f32x16 s; _Pragma("unroll") for (int i = 0; i < 16; ++i) s[i] = 0.f; \
    _Pragma("unroll") for (int d0 = 0; d0 < 4; ++d0) s = __builtin_amdgcn_mfma_f32_32x32x16_bf16(kf[d0], qr[d0], s, 0, 0, 0); \
    float mx = NEG; \
    _Pragma("unroll") for (int i = 0; i < 16; ++i) { const float raw = s[i]; float sc_; SCORE_EXPR; s[i] = sc_; mx = fmaxf(mx, sc_); } \
    mx = fmaxf(mx, __shfl_xor(mx, 32)); \
    const float mn = fmaxf(st.m, mx); const float alpha = __builtin_amdgcn_exp2f(st.m - mn); st.m = mn; \
    float ps = 0.f; \
    _Pragma("unroll") for (int i = 0; i < 16; ++i) { s[i] = __builtin_amdgcn_exp2f(s[i] - mn); ps += s[i]; } \
    st.l = st.l * alpha + ps; \
    _Pragma("unroll") for (int i = 0; i < 16; ++i) { st.o0[i] *= alpha; st.o1[i] *= alpha; } \
    { ALAS unsigned char* w_ = vst + ((lane & 7) >> 2) * 2048 + (lane >> 3) * 64 + (lane & 3) * 16; \
      _Pragma("unroll") for (int i = 0; i < 4; ++i) *(ALAS u32x4*)(w_ + i * 512) = vr[i]; } \
    u32x4 w0_, w1_; \
    w0_.x = cvtpk(s[0], s[1]); w0_.y = cvtpk(s[2], s[3]); w0_.z = cvtpk(s[4], s[5]); w0_.w = cvtpk(s[6], s[7]); \
    w1_.x = cvtpk(s[8], s[9]); w1_.y = cvtpk(s[10], s[11]); w1_.z = cvtpk(s[12], s[13]); w1_.w = cvtpk(s[14], s[15]); \
    const bf16x8 pa0_ = __builtin_bit_cast(bf16x8, w0_), pa1_ = __builtin_bit_cast(bf16x8, w1_); \
    { const ALAS unsigned char* rb_ = vst + (4 * hi + ((lane & 15) >> 2)) * 64 + ((lane >> 4) & 1) * 32 + (lane & 3) * 8; \
      v4i16_t a_, b_; bf16x8 vf_; \
      a_ = trrd(rb_);               b_ = trrd(rb_ + 512);        vf_ = (bf16x8){a_[0], a_[1], a_[2], a_[3], b_[0], b_[1], b_[2], b_[3]}; st.o0 = __builtin_amdgcn_mfma_f32_32x32x16_bf16(vf_, pa0_, st.o0, 0, 0, 0); \
      a_ = trrd(rb_ + 1024);        b_ = trrd(rb_ + 1024 + 512); vf_ = (bf16x8){a_[0], a_[1], a_[2], a_[3], b_[0], b_[1], b_[2], b_[3]}; st.o0 = __builtin_amdgcn_mfma_f32_32x32x16_bf16(vf_, pa1_, st.o0, 0, 0, 0); \
      a_ = trrd(rb_ + 2048);        b_ = trrd(rb_ + 2048 + 512); vf_ = (bf16x8){a_[0], a_[1], a_[2], a_[3], b_[0], b_[1], b_[2], b_[3]}; st.o1 = __builtin_amdgcn_mfma_f32_32x32x16_bf16(vf_, pa0_, st.o1, 0, 0, 0); \
      a_ = trrd(rb_ + 2048 + 1024); b_ = trrd(rb_ + 2048 + 1024 + 512); vf_ = (bf16x8){a_[0], a_[1], a_[2], a_[3], b_[0], b_[1], b_[2], b_[3]}; st.o1 = __builtin_amdgcn_mfma_f32_32x32x16_bf16(vf_, pa1_, st.o1, 0, 0, 0); } \
} while (0)

__device__ __forceinline__ void finish_unit(St& st, ALAS float* xs, int hw, int lane, const float* gain, bf16_t* Orow  ) {
    const int r32 = lane & 31, hi = lane >> 5;
    const float lt = st.l + __shfl_xor(st.l, 32); const float inv = 1.0f / lt;
    float sq = 0.f;
#pragma unroll
    for (int i = 0; i < 16; ++i) { st.o0[i] *= inv; st.o1[i] *= inv; sq += st.o0[i] * st.o0[i] + st.o1[i] * st.o1[i]; }
    sq += __shfl_xor(sq, 32);
    if (hi == 0) xs[hw * 32 + r32] = sq;
    __syncthreads();
    float tot = 0.f;
#pragma unroll
    for (int w = 0; w < 8; ++w) tot += xs[w * 32 + r32];
    const float rs = 1.0f / sqrtf(tot * (1.0f / 512.0f) + 1e-6f);
#pragma unroll
    for (int g = 0; g < 4; ++g) {
        const int d = 8 * g + 4 * hi;
        const f32x4 g0 = *(const f32x4*)(gain + hw * 64 + d), g1 = *(const f32x4*)(gain + hw * 64 + 32 + d);
        u32x2 a, b;
        a.x = cvtpk(st.o0[4 * g] * rs * g0[0], st.o0[4 * g + 1] * rs * g0[1]); a.y = cvtpk(st.o0[4 * g + 2] * rs * g0[2], st.o0[4 * g + 3] * rs * g0[3]);
        b.x = cvtpk(st.o1[4 * g] * rs * g1[0], st.o1[4 * g + 1] * rs * g1[1]); b.y = cvtpk(st.o1[4 * g + 2] * rs * g1[2], st.o1[4 * g + 3] * rs * g1[3]);
        *(u32x2*)(Orow + d) = a; *(u32x2*)(Orow + 32 + d) = b;
    }
}

__device__ __forceinline__ int t5_bucket_dev(int off) {
    const int n = off < 0 ? -off : off; int bk;
    if (n < 8) bk = n; else { int large = 8 + (int)(logf((float)n * 0.125f) / logf(128.0f) * 8.0f); bk = large < 15 ? large : 15; }
    return bk + (off > 0 ? 16 : 0);
}

__device__ __forceinline__ void dil_unit(int b, int t0, int a, int hw, int lane, const bf16_t* QKV, bf16_t* O, const float* gain, const ALAS float* tbl, ALAS unsigned char* vst, ALAS float* xs) {
    const int r32 = lane & 31, hi = lane >> 5, h = 8 + hw;
    const size_t rowb = (size_t)b * SEQ;
    const int qpos = t0 + a + 4 * r32;
    bf16x8 qr[4];
    { const bf16_t* qp = QKV + (rowb + qpos) * QKV_LD + h * 64 + hi * 8;
#pragma unroll
      for (int d0 = 0; d0 < 4; ++d0) qr[d0] = *(const bf16x8*)(qp + 16 * d0); }
    const bf16_t* Kb = QKV + rowb * QKV_LD + 1024 + h * 64 + hi * 8;
    const bf16_t* Vb = QKV + rowb * QKV_LD + 2048 + h * 64 + (lane & 7) * 8;
    St st;
#pragma unroll
    for (int i = 0; i < 16; ++i) { st.o0[i] = 0.f; st.o1[i] = 0.f; }
    st.m = NEG; st.l = 0.f;
#define DIL_TILE_DESC(ti, ap, ls) do { if ((ti) < 17) { ap = a; ls = -256 + 32 * (ti); } else { ap = (a + 1 + (((ti) - 17) >> 1)) & 3; ls = -16 + 32 * (((ti) - 17) & 1); } } while (0)
#define DIL_LOAD(ti, KF, VR) do { int ap_, ls_; DIL_TILE_DESC(ti, ap_, ls_); const int kb0_ = t0 + ap_ + 4 * ls_; \
        int kp_ = kb0_ + 4 * r32; kp_ = kp_ < 0 ? 0 : (kp_ > SEQ - 1 ? SEQ - 1 : kp_); const bf16_t* kpp_ = Kb + (size_t)kp_ * QKV_LD; \
        _Pragma("unroll") for (int d0 = 0; d0 < 4; ++d0) KF[d0] = *(const bf16x8*)(kpp_ + 16 * d0); \
        _Pragma("unroll") for (int i = 0; i < 4; ++i) { int vp_ = kb0_ + 4 * (8 * i + (lane >> 3)); vp_ = vp_ < 0 ? 0 : (vp_ > SEQ - 1 ? SEQ - 1 : vp_); VR[i] = *(const u32x4*)(Vb + (size_t)vp_ * QKV_LD); } } while (0)
    bf16x8 kf[4], kfn[4]; u32x4 vr[4], vrn[4];
    DIL_LOAD(0, kf, vr);
    for (int ti = 0; ti < 23; ++ti) {
        const int tn = ti + 1 < 23 ? ti + 1 : 22;
        DIL_LOAD(tn, kfn, vrn);
        int ap, ls; DIL_TILE_DESC(ti, ap, ls);
        const int kb0 = t0 + ap + 4 * ls;
        const int idx0 = (ap - a) + 4 * (ls + 4 * hi - r32) + DIL_OFF0;
        const ALAS float* tp = tbl + idx0;
        if (kb0 >= 0 && kb0 + 4 * 31 < SEQ) {
            ATT_TILE(sc_ = raw * SC + tp[4 * ((i & 3) + 8 * (i >> 2))]);
        } else {
            const int kp0 = kb0 + 16 * hi;
            ATT_TILE({ const int kp_ = kp0 + 4 * ((i & 3) + 8 * (i >> 2)); sc_ = ((unsigned)kp_ < (unsigned)SEQ) ? raw * SC + tp[4 * ((i & 3) + 8 * (i >> 2))] : NEG; });
        }
#pragma unroll
        for (int d0 = 0; d0 < 4; ++d0) { kf[d0] = kfn[d0]; vr[d0] = vrn[d0]; }
    }
#undef DIL_LOAD
#undef DIL_TILE_DESC
    finish_unit(st, xs, hw, lane, gain, O + (rowb + qpos) * O_LD + 512 + hw * 64);
}

__device__ __forceinline__ void na_unit(int b, int r, int j, int hw, int lane, const bf16_t* QKV, bf16_t* O, const float* gain, const ALAS float* tbl, ALAS unsigned char* vst, ALAS float* xs) {
    const int r32 = lane & 31, hi = lane >> 5, h = hw;
    const size_t rowb = (size_t)b * SEQ;
    const int qc = 32 * j + r32, qpos = r * 64 + qc;
    int R0 = r - 4; R0 = R0 < 0 ? 0 : (R0 > 56 ? 56 : R0);
    int qcs = qc - 8; qcs = qcs < 0 ? 0 : (qcs > 48 ? 48 : qcs);
    const int cstart = j ? 24 : 0;
    bf16x8 qr[4];
    { const bf16_t* qp = QKV + (rowb + qpos) * QKV_LD + h * 64 + hi * 8;
#pragma unroll
      for (int d0 = 0; d0 < 4; ++d0) qr[d0] = *(const bf16x8*)(qp + 16 * d0); }
    const bf16_t* Kb = QKV + rowb * QKV_LD + 1024 + h * 64 + hi * 8;
    const bf16_t* Vb = QKV + rowb * QKV_LD + 2048 + h * 64 + (lane & 7) * 8;
    St st;
#pragma unroll
    for (int i = 0; i < 16; ++i) { st.o0[i] = 0.f; st.o1[i] = 0.f; }
    st.m = NEG; st.l = 0.f;
#define NA_LOAD(ti, KF, VR) do { const int rg_ = (ti) / 5, cg_ = (ti) % 5; \
        const int kp_ = (R0 + 4 * rg_ + (r32 >> 3)) * 64 + cstart + 8 * cg_ + (r32 & 7); const bf16_t* kpp_ = Kb + (size_t)kp_ * QKV_LD; \
        _Pragma("unroll") for (int d0 = 0; d0 < 4; ++d0) KF[d0] = *(const bf16x8*)(kpp_ + 16 * d0); \
        _Pragma("unroll") for (int i = 0; i < 4; ++i) { const int jj_ = 8 * i + (lane >> 3); const int vp_ = (R0 + 4 * rg_ + (jj_ >> 3)) * 64 + cstart + 8 * cg_ + (jj_ & 7); VR[i] = *(const u32x4*)(Vb + (size_t)vp_ * QKV_LD); } } while (0)
    bf16x8 kf[4], kfn[4]; u32x4 vr[4], vrn[4];
    NA_LOAD(0, kf, vr);
    for (int ti = 0; ti < 10; ++ti) {
        const int tn = ti + 1 < 10 ? ti + 1 : 9;
        NA_LOAD(tn, kfn, vrn);
        const int rg = ti / 5, cg = ti % 5;
        const int kc0 = cstart + 8 * cg + 4 * hi;
        const int e0 = kc0 - qcs;
        const ALAS float* tp = tbl + 32 + (R0 + 4 * rg - r + 7) * 31 + (kc0 - qc + 15);
        ATT_TILE(sc_ = ((unsigned)(e0 + (i & 3)) < 16u) ? raw * SC + tp[(i >> 2) * 31 + (i & 3)] : NEG);
#pragma unroll
        for (int d0 = 0; d0 < 4; ++d0) { kf[d0] = kfn[d0]; vr[d0] = vrn[d0]; }
    }
#undef NA_LOAD
    finish_unit(st, xs, hw, lane, gain, O + (rowb + qpos) * O_LD + hw * 64);
}

__device__ __forceinline__ void attn_phase(ALAS unsigned char* lds, const bf16_t* QKV, bf16_t* O, const float* na_bias, const float* t5_bias, const float* na_g, const float* dil_g, int vcu, int G) {
    const int tid = threadIdx.x, lane = tid & 63, hw = __builtin_amdgcn_readfirstlane(tid >> 6);
    ALAS float* tbl = (ALAS float*)(lds + LDS_TBL + hw * TBL_BYTES);
    ALAS unsigned char* vst = lds + LDS_VST + hw * 4096;
    ALAS float* xs = (ALAS float*)(lds + LDS_XS);
    for (int idx = lane; idx < 2 * DIL_OFF0 + 1; idx += 64) {
        const int off = idx - DIL_OFF0, n = off < 0 ? -off : off;
        const int mult = (n <= 64 ? 1 : 0) + (((off & 3) == 0 && n <= 256) ? 1 : 0) + (((off & 15) == 0 && n <= 1024) ? 1 : 0);
        float v = NEG;
        if (mult > 0) v = t5_bias[hw * 32 + t5_bucket_dev(off)] * LOG2E + (mult == 1 ? 0.f : (mult == 2 ? 1.0f : 1.5849625007211562f));
        tbl[idx] = v;
    }
    __syncthreads();
    int ucount = 0;
    const int per = (1024 % G == 0) ? 1024 / G : 0;
    for (int i = 0;; ++i) {
        const int L = i * G + vcu; if (L >= 1024) break;
        const int U = per ? (L % G) * per + L / G : L;
        const int b = U >> 7, rest = U & 127;
        dil_unit(b, (rest >> 2) * 128, rest & 3, hw, lane, QKV, O, dil_g, tbl, vst, xs + (ucount & 1) * 256);
        ++ucount;
    }
    __syncthreads();
    for (int idx = lane; idx < 465; idx += 64) tbl[32 + idx] = na_bias[hw * 465 + idx] * LOG2E;
    __syncthreads();
    for (int i = 0;; ++i) {
        const int L = i * G + vcu; if (L >= 1024) break;
        const int U = per ? (L % G) * per + L / G : L;
        const int b = U >> 7, rest = U & 127;
        na_unit(b, rest >> 1, rest & 1, hw, lane, QKV, O, na_g, tbl, vst, xs + (ucount & 1) * 256);
        ++ucount;
    }
    __syncthreads();
}
#undef ATT_TILE
}

#define GAS __attribute__((address_space(1)))
#define LAS __attribute__((address_space(3)))
typedef unsigned short bf16;
typedef unsigned v4u __attribute__((ext_vector_type(4)));
typedef float f32x4 __attribute__((ext_vector_type(4)));
typedef short bf16x8 __attribute__((ext_vector_type(8)));
typedef GAS unsigned gu32;
typedef GAS unsigned long long gu64;
#define RLX_AGENT __ATOMIC_RELAXED, __HIP_MEMORY_SCOPE_AGENT
#define LDS_WAIT() asm volatile("s_waitcnt lgkmcnt(0)" ::: "memory")
#define VM_WAIT() asm volatile("s_waitcnt vmcnt(0)" ::: "memory")
__device__ __forceinline__ unsigned long long rt() { return __builtin_amdgcn_s_memrealtime(); }
__device__ __forceinline__ unsigned f2bf(float f) { unsigned u = __builtin_bit_cast(unsigned, f); return (u + 0x7fffu + ((u >> 16) & 1u)) >> 16; }
__device__ __forceinline__ unsigned pk2(float lo, float hi) { return f2bf(lo) | (f2bf(hi) << 16); }

#define XB_TMO      128
#define XB_XCNT(j)  (256  + 64 * (j))
#define XB_XSUB(j)  (1280 + 64 * (j))
#define XB_XGEN(j)  (2304 + 64 * (j))
#define XB_TOP      3328
#define XB_TOPGEN   3392
#define XCD_BAR_WORDS 3456
#define XB_SPIN_CAP (1u << 18)

__device__ __forceinline__ unsigned xb_ld(unsigned* p)              { return __hip_atomic_load(p, __ATOMIC_RELAXED, __HIP_MEMORY_SCOPE_AGENT); }
__device__ __forceinline__ unsigned xb_add(unsigned* p, unsigned v) { return __hip_atomic_fetch_add(p, v, __ATOMIC_RELAXED, __HIP_MEMORY_SCOPE_AGENT); }
__device__ __forceinline__ unsigned xb_xcc_id() { return (unsigned)__builtin_amdgcn_s_getreg((3 << 11) | 20) & 0xFu; }
#define XB_SPIN(cond, bar) do { unsigned _sp = 0; while (cond) { __builtin_amdgcn_s_sleep(1); \
    if ((++_sp & 255u) == 0u) { if (xb_ld(&(bar)[XB_TMO])) break; if (_sp > XB_SPIN_CAP) { atomicAdd(&(bar)[XB_TMO], 1u); break; } } } } while (0)

struct XcdBarrier {
    unsigned* bar; unsigned x;
    volatile LAS unsigned* st;
};

__device__ __forceinline__ XcdBarrier xcd_barrier_post(unsigned* bar, volatile LAS unsigned* st) {
    XcdBarrier b; b.bar = bar; b.x = xb_xcc_id(); b.st = st;
    if (threadIdx.x == 0) (void)xb_add(&bar[XB_XCNT(b.x)], 1u);
    return b;
}
__device__ __forceinline__ void xcd_barrier_complete(unsigned* bar, unsigned x, unsigned& nloc, unsigned& nx) {
    const unsigned G = gridDim.x * gridDim.y * gridDim.z;
    unsigned sum, cnt, mine, sp = 0u;
    for (;;) {
        sum = 0u; cnt = 0u; mine = 0u;
#pragma unroll
        for (unsigned j = 0; j < 16; ++j) { const unsigned c = xb_ld(&bar[XB_XCNT(j)]); sum += c; cnt += (c > 0u) ? 1u : 0u; mine = (j == x) ? c : mine; }
        if (sum == G) break;
        __builtin_amdgcn_s_sleep(1);
        if ((++sp & 255u) == 0u) { if (xb_ld(&bar[XB_TMO])) break; if (sp > XB_SPIN_CAP) { atomicAdd(&bar[XB_TMO], 1u); break; } }
    }
    nloc = mine > 0u ? mine : 1u; nx = cnt > 0u ? cnt : 1u;
}

__device__ __forceinline__ void xcd_barrier(const XcdBarrier& b) {
    asm volatile("s_waitcnt vmcnt(0)" ::: "memory");
    __syncthreads();
    if (threadIdx.x == 0) {
        unsigned* bar = b.bar;
        __builtin_amdgcn_s_waitcnt(0);
        unsigned nloc = b.st[0], nx = b.st[1];
        if (nloc == 0u) { xcd_barrier_complete(bar, b.x, nloc, nx); b.st[0] = nloc; b.st[1] = nx; }
        const unsigned old = xb_add(&bar[XB_XSUB(b.x)], 1u);
        const unsigned gen = old / nloc;
        if (old + 1u == (gen + 1u) * nloc) {
            __builtin_amdgcn_fence(__ATOMIC_RELEASE, "agent");
            asm volatile("s_waitcnt vmcnt(0)" ::: "memory");
            const unsigned og = xb_add(&bar[XB_TOP], 1u);
            const unsigned tg = og / nx;
            if (og + 1u == (tg + 1u) * nx) xb_add(&bar[XB_TOPGEN], 1u);
            else XB_SPIN(xb_ld(&bar[XB_TOPGEN]) == tg, bar);
            __builtin_amdgcn_fence(__ATOMIC_ACQUIRE, "agent");
            xb_add(&bar[XB_XGEN(b.x)], 1u);
            asm volatile("s_waitcnt vmcnt(0)" ::: "memory");
        } else {
            XB_SPIN(xb_ld(&bar[XB_XGEN(b.x)]) == gen, bar);
            __builtin_amdgcn_fence(__ATOMIC_ACQUIRE, "agent");
            asm volatile("s_waitcnt vmcnt(0)" ::: "memory");
        }
    }
    __syncthreads();
}
constexpr int NWAVES = 8;
constexpr int BATCH = 8, SEQ = 4096, D = 1024, M = BATCH * SEQ, FF = 2816, NGU = 2 * FF, NQKV = 3072;
constexpr float NORM_EPS = 1e-6f;
constexpr size_t MiB = 1u << 20;
constexpr size_t WS_CTL = 0, CTL_ZERO_BYTES = 1 * MiB;
constexpr size_t WS_WGU1 = 2 * MiB, WS_WD1 = 13 * MiB, WS_WGU2 = 19 * MiB, WS_WD2 = 30 * MiB, WS_WQKV = 36 * MiB, WS_WO = 42 * MiB;
constexpr size_t WS_SSQ = 44 * MiB;
constexpr size_t WS_XN = 48 * MiB;
constexpr size_t WS_H = 112 * MiB;
constexpr size_t WS_Y = 304 * MiB;
constexpr size_t WS_O = 432 * MiB;
constexpr size_t WS_END = 496 * MiB;
constexpr int CW_BAR = 4096;
constexpr int RING_BYTES = 131072, LDSCTL_OFF = RING_BYTES, MISC_OFF = LDSCTL_OFF + 320, LDS_BYTES = 147456;
static_assert(att::LDS_BYTES <= RING_BYTES, "attention LDS");

__device__ __forceinline__ float wave_sum(float v) {
#pragma unroll
    for (int o = 1; o < 64; o <<= 1) v += __shfl_xor(v, o);
    return v;
}
__device__ __forceinline__ void p0_transpose_item(const float* W, int K, int N, bf16* WT, int gu  , LAS float* scr, int item, int lane) {
    const int nblk = N / 32, kb = item / nblk, nb = item % nblk, k0 = 64 * kb, n0 = 32 * nb;
    const int drow0 = gu < 0 ? n0 : ((n0 >> 7) * 256 + gu * 128 + (n0 & 127));
#pragma unroll 8
    for (int i = 0; i < 32; ++i) { const int kk = 2 * i + (lane >> 5); scr[kk * 33 + (lane & 31)] = W[(size_t)(k0 + kk) * N + n0 + (lane & 31)]; }
    LDS_WAIT(); asm volatile("" ::: "memory");
    const int c = lane & 7;
#pragma unroll
    for (int j = 0; j < 4; ++j) { const int n = (lane >> 3) + 8 * j; const LAS float* s = scr + (8 * c) * 33 + n;
        v4u o; o.x = pk2(s[0 * 33], s[1 * 33]); o.y = pk2(s[2 * 33], s[3 * 33]); o.z = pk2(s[4 * 33], s[5 * 33]); o.w = pk2(s[6 * 33], s[7 * 33]);
        *(GAS v4u*)(WT + (size_t)(drow0 + n) * K + k0 + 8 * c) = o; }
    LDS_WAIT(); asm volatile("" ::: "memory");
}
__device__ __forceinline__ void rms_row_to_bf16(const float* xrow, const float* g, bf16* orow, int lane) {
    const GAS f32x4* xr = (const GAS f32x4*)xrow + lane; const GAS f32x4* gr = (const GAS f32x4*)g + lane;
    f32x4 v[4]; float s = 0.f;
#pragma unroll
    for (int j = 0; j < 4; ++j) { v[j] = xr[64 * j]; s += (v[j].x * v[j].x + v[j].y * v[j].y) + (v[j].z * v[j].z + v[j].w * v[j].w); }
    const float rs = 1.f / sqrtf(wave_sum(s) * (1.f / D) + NORM_EPS);
    GAS unsigned long long* o8 = (GAS unsigned long long*)orow + lane;
#pragma unroll
    for (int j = 0; j < 4; ++j) { const f32x4 gg = gr[64 * j]; o8[64 * j] = (unsigned long long)pk2(v[j].x * rs * gg.x, v[j].y * rs * gg.y) | ((unsigned long long)pk2(v[j].z * rs * gg.z, v[j].w * rs * gg.w) << 32); }
}
__device__ __forceinline__ void resid_row(const float* yrow, const float* ssq16, const float* xi, float* xo, const float* gpost, float coef, const float* gpre, bf16* xnrow, int lane) {
    const GAS f32x4* yr = (const GAS f32x4*)yrow + lane; const GAS f32x4* xr = (const GAS f32x4*)xi + lane; const GAS f32x4* gr = (const GAS f32x4*)gpost + lane;
    float p = (lane < 16) ? ssq16[lane] : 0.f; p = wave_sum(p);
    const float rs = coef / sqrtf(p * (1.f / D) + NORM_EPS);
    f32x4 v[4]; float s = 0.f;
#pragma unroll
    for (int j = 0; j < 4; ++j) { const f32x4 y = yr[64 * j], x = xr[64 * j], g = gr[64 * j]; v[j] = x + y * rs * g; s += (v[j].x * v[j].x + v[j].y * v[j].y) + (v[j].z * v[j].z + v[j].w * v[j].w); }
    GAS f32x4* orr = (GAS f32x4*)xo + lane;
#pragma unroll
    for (int j = 0; j < 4; ++j) orr[64 * j] = v[j];
    if (gpre) {
        const float rs2 = 1.f / sqrtf(wave_sum(s) * (1.f / D) + NORM_EPS);
        const GAS f32x4* g2 = (const GAS f32x4*)gpre + lane; GAS unsigned long long* o8 = (GAS unsigned long long*)xnrow + lane;
#pragma unroll
        for (int j = 0; j < 4; ++j) { const f32x4 gg = g2[64 * j]; o8[64 * j] = (unsigned long long)pk2(v[j].x * rs2 * gg.x, v[j].y * rs2 * gg.y) | ((unsigned long long)pk2(v[j].z * rs2 * gg.z, v[j].w * rs2 * gg.w) << 32); }
    }
}

struct Args { const float* in[19]; float* out; unsigned char* ws; int ph_lo, ph_hi, li, pad; };
__global__ void __launch_bounds__(NWAVES * 64, 2) mk_fwd(Args args) {
    extern __shared__ __attribute__((aligned(16))) unsigned char lds[];
    LAS unsigned char* L = (LAS unsigned char*)lds;
    volatile LAS unsigned* MISC = (volatile LAS unsigned*)(L + MISC_OFF);
    const int tid = threadIdx.x, lane = tid & 63, wave = __builtin_amdgcn_readfirstlane(tid >> 6);
    const int G = gridDim.x; const int bx = blockIdx.x; const int vcu = (G % 8 == 0) ? (bx % 8) * (G / 8) + bx / 8 : bx;
    unsigned char* ws = args.ws;
    gu32* ctl = (gu32*)(ws + WS_CTL);
    const float* x = args.in[0];
    float* out = args.out;
    bf16 *WGU1 = (bf16*)(ws + WS_WGU1), *WD1 = (bf16*)(ws + WS_WD1), *WGU2 = (bf16*)(ws + WS_WGU2), *WD2 = (bf16*)(ws + WS_WD2), *WQKV = (bf16*)(ws + WS_WQKV), *WO = (bf16*)(ws + WS_WO);
    bf16 *XN = (bf16*)(ws + WS_XN), *HB = (bf16*)(ws + WS_H), *OB = (bf16*)(ws + WS_O);
    float *Y = (float*)(ws + WS_Y), *SSQ = (float*)(ws + WS_SSQ);
    for (int u = tid; u < (LDS_BYTES - LDSCTL_OFF) / 4; u += NWAVES * 64) ((LAS unsigned*)(L + LDSCTL_OFF))[u] = 0u;
    __syncthreads();
    XcdBarrier bar = xcd_barrier_post((unsigned*)(ctl + CW_BAR) + args.li * XCD_BAR_WORDS, MISC + 8);
    const int lo = args.ph_lo, hi = args.ph_hi;
#define IN(k) (lo <= (k) && (k) < hi)
#define SEAM(k) do { if (IN(k) && IN((k) + 1)) xcd_barrier(bar); } while (0)
    const int gw = vcu * NWAVES + wave, NGW = G * NWAVES;

    if (IN(0)) {
        LAS float* scr = (LAS float*)(L + wave * 16384);
        constexpr int I_GU = (D / 64) * (FF / 32), I_DN = (FF / 64) * (D / 32), I_QKV = (D / 64) * (NQKV / 32), I_O = (D / 64) * (D / 32);
        constexpr int NITEMS = 4 * I_GU + 2 * I_DN + I_QKV + I_O;
        for (int it = gw; it < NITEMS; it += NGW) {
            int r = it;
            if (r < I_GU) { p0_transpose_item(args.in[2], D, FF, WGU1, 0, scr, r, lane); continue; } r -= I_GU;
            if (r < I_GU) { p0_transpose_item(args.in[3], D, FF, WGU1, 1, scr, r, lane); continue; } r -= I_GU;
            if (r < I_GU) { p0_transpose_item(args.in[15], D, FF, WGU2, 0, scr, r, lane); continue; } r -= I_GU;
            if (r < I_GU) { p0_transpose_item(args.in[16], D, FF, WGU2, 1, scr, r, lane); continue; } r -= I_GU;
            if (r < I_DN) { p0_transpose_item(args.in[4], FF, D, WD1, -1, scr, r, lane); continue; } r -= I_DN;
            if (r < I_DN) { p0_transpose_item(args.in[17], FF, D, WD2, -1, scr, r, lane); continue; } r -= I_DN;
            if (r < I_QKV) { p0_transpose_item(args.in[7], D, NQKV, WQKV, -1, scr, r, lane); continue; } r -= I_QKV;
            p0_transpose_item(args.in[12], D, D, WO, -1, scr, r, lane);
        }
        for (int m = gw; m < M; m += NGW) rms_row_to_bf16(x + (size_t)m * D, args.in[1], XN + (size_t)m * D, lane);
    }
    SEAM(0);
    if (IN(1)) { pg8::Gemm g{XN, WGU1, M, NGU, D}; pg8::StaticOrder S; S.init(M, NGU, G, bx); pg8::EpiSwiGLU E{HB, FF};
        pg8::gemm_phase<pg8::EpiSwiGLU, pg8::StaticOrder, true, true>(L, g, S, E); }
    SEAM(1);
    if (IN(2)) { pg8::Gemm g{HB, WD1, M, D, FF}; pg8::StaticOrder S; S.init(M, D, G, bx); pg8::EpiF32Ssq E{Y, D, SSQ};
        pg8::gemm_phase<pg8::EpiF32Ssq, pg8::StaticOrder, true, true>(L, g, S, E); }
    SEAM(2);
    if (IN(3)) { for (int m = gw; m < M; m += NGW) resid_row(Y + (size_t)m * D, SSQ + (size_t)m * 16, x + (size_t)m * D, out + (size_t)m * D, args.in[5], 0.5f, args.in[6], XN + (size_t)m * D, lane); }
    SEAM(3);
    if (IN(4)) { pg8::Gemm g{XN, WQKV, M, NQKV, D}; pg8::StaticOrder S; S.init(M, NQKV, G, bx); pg8::EpiBf16 E{HB, NQKV};
        pg8::gemm_phase<pg8::EpiBf16, pg8::StaticOrder, true, true>(L, g, S, E); }
    SEAM(4);
    if (IN(5)) { att::attn_phase(L, HB, OB, args.in[8], args.in[9], args.in[10], args.in[11], vcu, G); }
    SEAM(5);
    if (IN(6)) { pg8::Gemm g{OB, WO, M, D, D}; pg8::StaticOrder S; S.init(M, D, G, bx); pg8::EpiF32Ssq E{Y, D, SSQ};
        pg8::gemm_phase<pg8::EpiF32Ssq, pg8::StaticOrder, true, true>(L, g, S, E); }
    SEAM(6);
    if (IN(7)) { for (int m = gw; m < M; m += NGW) resid_row(Y + (size_t)m * D, SSQ + (size_t)m * 16, out + (size_t)m * D, out + (size_t)m * D, args.in[13], 1.0f, args.in[14], XN + (size_t)m * D, lane); }
    SEAM(7);
    if (IN(8)) { pg8::Gemm g{XN, WGU2, M, NGU, D}; pg8::StaticOrder S; S.init(M, NGU, G, bx); pg8::EpiSwiGLU E{HB, FF};
        pg8::gemm_phase<pg8::EpiSwiGLU, pg8::StaticOrder, true, true>(L, g, S, E); }
    SEAM(8);
    if (IN(9)) { pg8::Gemm g{HB, WD2, M, D, FF}; pg8::StaticOrder S; S.init(M, D, G, bx); pg8::EpiF32Ssq E{Y, D, SSQ};
        pg8::gemm_phase<pg8::EpiF32Ssq, pg8::StaticOrder, true, true>(L, g, S, E); }
    SEAM(9);
    if (IN(10)) { for (int m = gw; m < M; m += NGW) resid_row(Y + (size_t)m * D, SSQ + (size_t)m * 16, out + (size_t)m * D, out + (size_t)m * D, args.in[18], 0.5f, nullptr, nullptr, lane); }
#undef IN
#undef SEAM
}

constexpr int N_PHASES = 11;
#ifndef MK_N_LAUNCHES
#define MK_N_LAUNCHES 1
#endif
extern "C" void kernel_launch(void* const* d_in, const int* in_sizes, int n_in, void* d_out, int out_size, void* d_ws, size_t ws_size, hipStream_t stream) {
    static int grid = 0;
    if (grid == 0) {
        if (n_in != 19 || in_sizes[0] != M * D || out_size != M * D || ws_size < WS_END) { fprintf(stderr, "kernel_launch: unexpected shapes (n_in %d, in0 %d, out %d, ws %zu)\n", n_in, n_in > 0 ? in_sizes[0] : -1, out_size, ws_size); grid = -1; return; }
        int dev = 0, cus = 0, per_cu = 0;
        if (hipGetDevice(&dev) != hipSuccess || hipDeviceGetAttribute(&cus, hipDeviceAttributeMultiprocessorCount, dev) != hipSuccess) { grid = -1; return; }
        if (hipFuncSetAttribute((const void*)mk_fwd, hipFuncAttributeMaxDynamicSharedMemorySize, LDS_BYTES) != hipSuccess) { fprintf(stderr, "kernel_launch: hipFuncSetAttribute failed\n"); grid = -1; return; }
        if (hipOccupancyMaxActiveBlocksPerMultiprocessor(&per_cu, (const void*)mk_fwd, NWAVES * 64, LDS_BYTES) != hipSuccess || per_cu < 1) { fprintf(stderr, "kernel_launch: occupancy query says %d blocks per CU\n", per_cu); }
        (void)hipGetLastError();
        grid = cus;
    }
    if (grid < 0) return;
    (void)hipMemsetAsync((char*)d_ws + WS_CTL, 0, CTL_ZERO_BYTES, stream);
    Args a{};
    for (int i = 0; i < 19; ++i) a.in[i] = (const float*)d_in[i];
    a.out = (float*)d_out; a.ws = (unsigned char*)d_ws;
    if (MK_N_LAUNCHES == 1) { a.ph_lo = 0; a.ph_hi = N_PHASES; a.li = 0; hipLaunchKernelGGL(mk_fwd, dim3(grid), dim3(NWAVES * 64), LDS_BYTES, stream, a); }
    else { for (int p = 0; p < N_PHASES; ++p) { a.ph_lo = p; a.ph_hi = p + 1; a.li = 0; hipLaunchKernelGGL(mk_fwd, dim3(grid), dim3(NWAVES * 64), LDS_BYTES, stream, a); } }
}
```
